# Optimizing an MI355X kernel written in HIP

```python
import math
import jax, jax.numpy as jnp
from jax import lax
import numpy as np

D_MODEL = 1024
BATCH = 8
SEQ = 2048
DEPTH = 1

N_HEADS = 8
HEAD_DIM = 128
ATTN_WIDTH = N_HEADS * HEAD_DIM
CONV_WIDTH = D_MODEL
CONV_K = 3
MOBA_BLOCK = 256
MOBA_TOPK = 3
QUERY_CHUNK = 64
D_FF = 2816
LN_EPS = 1e-5
ALPHA = (2.0 * DEPTH) ** 0.25
BETA = (8.0 * DEPTH) ** -0.25
SPLITS = (ATTN_WIDTH, 2 * ATTN_WIDTH, 3 * ATTN_WIDTH,
          3 * ATTN_WIDTH + CONV_WIDTH, 3 * ATTN_WIDTH + 2 * CONV_WIDTH,
          3 * ATTN_WIDTH + 3 * CONV_WIDTH)
PROJ_COLS = 3 * ATTN_WIDTH + 3 * CONV_WIDTH + 2 * D_MODEL

kernel_name = "hybrid_moba_shortconv_macaron_deepnorm"


def layer_norm(x, g, b):
    xf = x.astype(jnp.float32)
    mu = jnp.mean(xf, axis=-1, keepdims=True)
    var = jnp.mean(jnp.square(xf - mu), axis=-1, keepdims=True)
    return ((xf - mu) * lax.rsqrt(var + LN_EPS) * g + b).astype(x.dtype)


def swiglu(x, w_up, w_down):
    gate, up = jnp.split(x @ w_up, 2, axis=-1)
    return (jax.nn.silu(gate) * up) @ w_down


def moba_attention(q, k, v):
    B, H, S, hd = q.shape
    nb = -(-S // MOBA_BLOCK)
    s_pad = nb * MOBA_BLOCK
    pad = [(0, 0), (0, 0), (0, s_pad - S), (0, 0)]
    q, k, v = (jnp.pad(t, pad) for t in (q, k, v))
    scale = hd ** -0.5
    kb = k.reshape(B, H, nb, MOBA_BLOCK, hd)
    vb = v.reshape(B, H, nb, MOBA_BLOCK, hd)
    k_mean = jnp.mean(kb.astype(jnp.float32), axis=3)
    gate = jnp.einsum('bhsd,bhnd->bhsn', q.astype(jnp.float32), k_mean)
    q_blk = jnp.arange(s_pad) // MOBA_BLOCK
    past = jnp.arange(nb)[None, :] < q_blk[:, None]
    gate = jnp.where(past, gate, -jnp.inf)
    n_slots = max(1, min(MOBA_TOPK, nb))
    _, sel = lax.top_k(gate, n_slots)
    sel = sel.astype(jnp.int32)

    n_chunks = s_pad // QUERY_CHUNK
    q_items = q.reshape(B, H, n_chunks, QUERY_CHUNK, hd).transpose(0, 2, 1, 3, 4)
    q_items = q_items.reshape(B * n_chunks, H, QUERY_CHUNK, hd)
    idx_items = sel.reshape(B, H, n_chunks, QUERY_CHUNK, n_slots).transpose(0, 2, 1, 3, 4)
    idx_items = idx_items.reshape(B * n_chunks, H, QUERY_CHUNK, n_slots)
    b_ids = jnp.repeat(jnp.arange(B, dtype=jnp.int32), n_chunks)
    c_ids = jnp.tile(jnp.arange(n_chunks, dtype=jnp.int32), B)

    def one_chunk(args):
        qc, idx, b, c = args
        k_b = lax.dynamic_index_in_dim(kb, b, 0, keepdims=False)
        v_b = lax.dynamic_index_in_dim(vb, b, 0, keepdims=False)
        q_start = c * QUERY_CHUNK
        blk = q_start // MOBA_BLOCK
        k_own = lax.dynamic_index_in_dim(k_b, blk, 1, keepdims=False)
        v_own = lax.dynamic_index_in_dim(v_b, blk, 1, keepdims=False)
        k_sel = jax.vmap(lambda kh, ih: kh[ih])(k_b, idx)
        v_sel = jax.vmap(lambda vh, ih: vh[ih])(v_b, idx)
        s_sel = jnp.einsum('hqd,hqnkd->hqnk', qc, k_sel).astype(jnp.float32) * scale
        slot_ok = jnp.arange(n_slots) < blk
        s_sel = jnp.where(slot_ok[None, None, :, None], s_sel, -jnp.inf)
        s_sel = s_sel.reshape(H, QUERY_CHUNK, n_slots * MOBA_BLOCK)
        s_own = jnp.einsum('hqd,hkd->hqk', qc, k_own).astype(jnp.float32) * scale
        q_pos = q_start + jnp.arange(QUERY_CHUNK)
        k_pos = blk * MOBA_BLOCK + jnp.arange(MOBA_BLOCK)
        own_ok = k_pos[None, :] <= q_pos[:, None]
        s_own = jnp.where(own_ok[None], s_own, -jnp.inf)
        p = jax.nn.softmax(jnp.concatenate([s_sel, s_own], axis=-1), axis=-1)
        p_sel = p[..., :n_slots * MOBA_BLOCK].reshape(H, QUERY_CHUNK, n_slots, MOBA_BLOCK)
        p_own = p[..., n_slots * MOBA_BLOCK:]
        out = (jnp.einsum('hqnk,hqnkd->hqd', p_sel.astype(v_sel.dtype), v_sel)
               + jnp.einsum('hqk,hkd->hqd', p_own.astype(v_own.dtype), v_own))
        return out.astype(qc.dtype)

    out = lax.map(one_chunk, (q_items, idx_items, b_ids, c_ids))
    out = out.reshape(B, n_chunks, H, QUERY_CHUNK, hd).transpose(0, 1, 3, 2, 4)
    return out.reshape(B, s_pad, H * hd)[:, :S]


def short_conv(u, w, bias):
    y = lax.conv_general_dilated(
        u, w[:, None, :], window_strides=(1,), padding=[(CONV_K - 1, 0)],
        dimension_numbers=('NWC', 'WIO', 'NWC'), feature_group_count=u.shape[-1])
    return y + bias


def hybrid_mixer(x, w_in, b_gate, conv_w, conv_b, w_proj_attn, w_proj_conv, w_out):
    B, S, _ = x.shape
    z = x @ w_in
    q, k, v, h, g_b, g_c, gates = jnp.split(z, SPLITS, axis=-1)

    def heads(t):
        return t.reshape(B, S, N_HEADS, HEAD_DIM).transpose(0, 2, 1, 3)

    y_attn = moba_attention(heads(q), heads(k), heads(v)) @ w_proj_attn
    y_conv = (g_b * short_conv(g_c * h, conv_w, conv_b)) @ w_proj_conv
    gate_attn, gate_conv = jnp.split(jax.nn.sigmoid(gates + b_gate), 2, axis=-1)
    return (gate_attn * y_attn + gate_conv * y_conv) @ w_out


def setup_inputs(seed: int = 0) -> dict:
    key = jax.random.key(seed)
    ks = jax.random.split(key, 20)
    nrm = jax.random.normal
    L = DEPTH
    x = nrm(ks[0], (BATCH, SEQ, D_MODEL), jnp.float32)
    ffn1_w_up = nrm(ks[1], (L, D_MODEL, 2 * D_FF), jnp.float32) * D_MODEL ** -0.5
    ffn1_w_down = nrm(ks[2], (L, D_FF, D_MODEL), jnp.float32) * (D_FF ** -0.5 * BETA)
    ln1_g = 1.0 + 0.02 * nrm(ks[3], (L, D_MODEL), jnp.float32)
    ln1_b = 0.02 * nrm(ks[4], (L, D_MODEL), jnp.float32)
    col_scale = jnp.ones((PROJ_COLS,), jnp.float32).at[2 * ATTN_WIDTH:3 * ATTN_WIDTH].set(BETA)
    w_in = nrm(ks[5], (L, D_MODEL, PROJ_COLS), jnp.float32) * D_MODEL ** -0.5 * col_scale
    b_gate = 0.1 * nrm(ks[6], (L, 2 * D_MODEL), jnp.float32)
    conv_w = nrm(ks[7], (L, CONV_K, CONV_WIDTH), jnp.float32) * CONV_K ** -0.5
    conv_b = 0.02 * nrm(ks[8], (L, CONV_WIDTH), jnp.float32)
    w_proj_attn = nrm(ks[9], (L, ATTN_WIDTH, D_MODEL), jnp.float32) * ATTN_WIDTH ** -0.5
    w_proj_conv = nrm(ks[10], (L, CONV_WIDTH, D_MODEL), jnp.float32) * CONV_WIDTH ** -0.5
    w_out = nrm(ks[11], (L, D_MODEL, D_MODEL), jnp.float32) * (D_MODEL ** -0.5 * BETA)
    ln2_g = 1.0 + 0.02 * nrm(ks[12], (L, D_MODEL), jnp.float32)
    ln2_b = 0.02 * nrm(ks[13], (L, D_MODEL), jnp.float32)
    ffn2_w_up = nrm(ks[14], (L, D_MODEL, 2 * D_FF), jnp.float32) * D_MODEL ** -0.5
    ffn2_w_down = nrm(ks[15], (L, D_FF, D_MODEL), jnp.float32) * (D_FF ** -0.5 * BETA)
    ln3_g = 1.0 + 0.02 * nrm(ks[16], (L, D_MODEL), jnp.float32)
    ln3_b = 0.02 * nrm(ks[17], (L, D_MODEL), jnp.float32)
    return {"x": x, "ffn1_w_up": ffn1_w_up, "ffn1_w_down": ffn1_w_down,
            "ln1_g": ln1_g, "ln1_b": ln1_b, "w_in": w_in, "b_gate": b_gate,
            "conv_w": conv_w, "conv_b": conv_b, "w_proj_attn": w_proj_attn,
            "w_proj_conv": w_proj_conv, "w_out": w_out, "ln2_g": ln2_g, "ln2_b": ln2_b,
            "ffn2_w_up": ffn2_w_up, "ffn2_w_down": ffn2_w_down,
            "ln3_g": ln3_g, "ln3_b": ln3_b}


def reference(x, ffn1_w_up, ffn1_w_down, ln1_g, ln1_b, w_in, b_gate, conv_w, conv_b,
              w_proj_attn, w_proj_conv, w_out, ln2_g, ln2_b, ffn2_w_up, ffn2_w_down,
              ln3_g, ln3_b):
    for l in range(DEPTH):
        x = layer_norm(ALPHA * x + 0.5 * swiglu(x, ffn1_w_up[l], ffn1_w_down[l]), ln1_g[l], ln1_b[l])
        mix = hybrid_mixer(x, w_in[l], b_gate[l], conv_w[l], conv_b[l],
                           w_proj_attn[l], w_proj_conv[l], w_out[l])
        x = layer_norm(ALPHA * x + mix, ln2_g[l], ln2_b[l])
        x = layer_norm(ALPHA * x + 0.5 * swiglu(x, ffn2_w_up[l], ffn2_w_down[l]), ln3_g[l], ln3_b[l])
    return x
```

```cpp
#include <hip/hip_runtime.h>
#include <cstdio>
#include <cstdint>

constexpr int BATCH = 8, SEQ = 2048, D = 1024, T = BATCH * SEQ, FF = 2816, NH = 8, HD = 128, NBLK = 8, MB = 256;
constexpr float ALPHA = 1.189207115002721f;
constexpr float LN_EPS = 1e-5f;
constexpr float ATT_SCALE = 0.08838834764831845f;

typedef unsigned short bf16;
constexpr size_t MiB = 1u << 20;
constexpr size_t WS_CTL = 0, CTL_ZERO_BYTES = 1 * MiB;
constexpr size_t WS_KS = 512 * 1024;
constexpr size_t WS_XN = 60 * MiB;
constexpr size_t WS_Q = 92 * MiB, WS_K = 124 * MiB, WS_V = 156 * MiB, WS_P = 188 * MiB, WS_GB = 220 * MiB;
constexpr size_t WS_H = 92 * MiB;
constexpr size_t WS_R = WS_K, WS_GC = WS_V, WS_M = WS_P;
constexpr size_t WS_END = 256 * MiB;

__device__ __forceinline__ float bf2f(bf16 v) { return __uint_as_float(((unsigned)v) << 16); }
__device__ __forceinline__ bf16 f2bf(float f) { unsigned u = __float_as_uint(f); return (bf16)((u + 0x7fffu + ((u >> 16) & 1u)) >> 16); }
__device__ __forceinline__ float wave_sum(float v) {
#pragma unroll
    for (int o = 1; o < 64; o <<= 1) v += __shfl_xor(v, o);
    return v;
}
__device__ __forceinline__ float wave_max(float v) {
#pragma unroll
    for (int o = 1; o < 64; o <<= 1) v = fmaxf(v, __shfl_xor(v, o));
    return v;
}
__device__ __forceinline__ float sigmoidf_(float x) { return 1.f / (1.f + __expf(-x)); }

struct NArgs { const bf16* A0; const float* B0; const bf16* A1; const float* B1; const void* p0; const void* p1; void* p2; int lda0, ldb0, c0, lda1, ldb1, c1, K; float s; };
static_assert(sizeof(NArgs) == 88, "NArgs has no padding");
template <bool DUAL, class Epi>
__global__ __launch_bounds__(256) void naive_gemm(NArgs g) {
    const bf16* __restrict__ A0 = g.A0; const float* __restrict__ B0 = g.B0; const bf16* __restrict__ A1 = g.A1; const float* __restrict__ B1 = g.B1;
    const int lda0 = g.lda0, ldb0 = g.ldb0, c0 = g.c0, lda1 = g.lda1, ldb1 = g.ldb1, c1 = g.c1, K = g.K; const Epi epi{};
    __shared__ float As0[16][68], As1[16][68], Bs0[16][64], Bs1[16][64];
    const int tid = threadIdx.x, tx = tid & 15, ty = tid >> 4;
    const int row0 = blockIdx.y * 64, col0 = blockIdx.x * 64;
    float acc0[4][4], acc1[4][4];
#pragma unroll
    for (int i = 0; i < 4; ++i)
#pragma unroll
        for (int j = 0; j < 4; ++j) { acc0[i][j] = 0.f; acc1[i][j] = 0.f; }
    for (int k0 = 0; k0 < K; k0 += 16) {
#pragma unroll
        for (int i = 0; i < 4; ++i) {
            const int idx = tid + 256 * i;
            { const int r = idx >> 4, c = idx & 15; As0[c][r] = bf2f(A0[(size_t)(row0 + r) * lda0 + k0 + c]);
              if (DUAL) As1[c][r] = bf2f(A1[(size_t)(row0 + r) * lda1 + k0 + c]); }
            { const int k = idx >> 6, c = idx & 63; Bs0[k][c] = B0[(size_t)(k0 + k) * ldb0 + c0 + col0 + c];
              if (DUAL) Bs1[k][c] = B1[(size_t)(k0 + k) * ldb1 + c1 + col0 + c]; }
        }
        __syncthreads();
#pragma unroll
        for (int kk = 0; kk < 16; ++kk) {
            float a[4], b[4];
#pragma unroll
            for (int i = 0; i < 4; ++i) { a[i] = As0[kk][ty * 4 + i]; b[i] = Bs0[kk][tx * 4 + i]; }
#pragma unroll
            for (int i = 0; i < 4; ++i)
#pragma unroll
                for (int j = 0; j < 4; ++j) acc0[i][j] = fmaf(a[i], b[j], acc0[i][j]);
            if (DUAL) {
#pragma unroll
                for (int i = 0; i < 4; ++i) { a[i] = As1[kk][ty * 4 + i]; b[i] = Bs1[kk][tx * 4 + i]; }
#pragma unroll
                for (int i = 0; i < 4; ++i)
#pragma unroll
                    for (int j = 0; j < 4; ++j) acc1[i][j] = fmaf(a[i], b[j], acc1[i][j]);
            }
        }
        __syncthreads();
    }
#pragma unroll
    for (int i = 0; i < 4; ++i)
#pragma unroll
        for (int j = 0; j < 4; ++j) epi(g, row0 + ty * 4 + i, col0 + tx * 4 + j, acc0[i][j], acc1[i][j]);
}

struct E_Swiglu { __device__ void operator()(const NArgs& g, int r, int c, float a, float b) const { ((bf16*)g.p2)[(size_t)r * FF + c] = f2bf(a * sigmoidf_(a) * b); } };
struct E_PreLN { __device__ void operator()(const NArgs& g, int r, int c, float a, float) const { const size_t i = (size_t)r * D + c; ((float*)g.p2)[i] = ALPHA * ((const float*)g.p0)[i] + g.s * a; } };
struct E_QKV { __device__ void operator()(const NArgs& g, int r, int c, float a, float) const { ((bf16*)g.p2)[(size_t)(c >> 10) * ((size_t)T * D) + (size_t)r * D + (c & 1023)] = f2bf(a); } };
struct E_Mul { __device__ void operator()(const NArgs& g, int r, int c, float a, float b) const { ((bf16*)g.p2)[(size_t)r * D + c] = f2bf(a * b); } };
struct E_Plain { __device__ void operator()(const NArgs& g, int r, int c, float a, float) const { ((bf16*)g.p2)[(size_t)r * D + c] = f2bf(a); } };
struct E_Gates { __device__ void operator()(const NArgs& g, int r, int c, float a, float b) const {
    const float* bg = (const float*)g.p0; const float ga = sigmoidf_(a + bg[c]), gc = sigmoidf_(b + bg[D + c]); ((bf16*)g.p2)[(size_t)r * D + c] = f2bf(ga / gc); ((bf16*)g.p1)[(size_t)r * D + c] = f2bf(gc); } };
struct E_M { __device__ void operator()(const NArgs& g, int r, int c, float a, float b) const {
    const size_t i = (size_t)r * D + c; ((bf16*)g.p2)[i] = f2bf(bf2f(((const bf16*)g.p1)[i]) * (bf2f(((const bf16*)g.p0)[i]) * a + b)); } };

__global__ void k_cvt(const float* __restrict__ x, bf16* __restrict__ o, size_t n) {
    size_t i = (size_t)blockIdx.x * blockDim.x + threadIdx.x; if (i < n) o[i] = f2bf(x[i]);
}
__global__ __launch_bounds__(256) void k_ln(float* __restrict__ io, const float* __restrict__ g, const float* __restrict__ b, bf16* __restrict__ xn) {
    const int lane = threadIdx.x & 63, row = blockIdx.x * 4 + (threadIdx.x >> 6);
    float* p = io + (size_t)row * D; float v[16]; float s = 0.f;
#pragma unroll
    for (int j = 0; j < 16; ++j) { v[j] = p[lane + 64 * j]; s += v[j]; }
    const float mean = wave_sum(s) * (1.f / D); float q = 0.f;
#pragma unroll
    for (int j = 0; j < 16; ++j) { v[j] -= mean; q += v[j] * v[j]; }
    const float rstd = rsqrtf(wave_sum(q) * (1.f / D) + LN_EPS);
#pragma unroll
    for (int j = 0; j < 16; ++j) { const int c = lane + 64 * j; const float o = v[j] * rstd * g[c] + b[c]; p[c] = o; if (xn) xn[(size_t)row * D + c] = f2bf(o); }
}
__global__ __launch_bounds__(256) void k_ksum(const bf16* __restrict__ Kb, float* __restrict__ KS) {
    const int bb = blockIdx.x, col = blockIdx.y * 256 + threadIdx.x; float s = 0.f;
    for (int r = 0; r < MB; ++r) s += bf2f(Kb[((size_t)bb * MB + r) * D + col]);
    KS[(size_t)bb * D + col] = s;
}
__global__ __launch_bounds__(256) void k_conv(const bf16* __restrict__ P, bf16* __restrict__ GB, const float* __restrict__ cw, const float* __restrict__ cb) {
    const size_t i = (size_t)blockIdx.x * 256 + threadIdx.x; const int c = (int)(i & (D - 1)); const int tok = (int)(i >> 10), s = tok & (SEQ - 1);
    float y = cb[c] + cw[2 * D + c] * bf2f(P[i]);
    if (s >= 1) y += cw[D + c] * bf2f(P[i - D]);
    if (s >= 2) y += cw[c] * bf2f(P[i - 2 * D]);
    GB[i] = f2bf(bf2f(GB[i]) * y);
}
__global__ __launch_bounds__(256) void k_attn(bf16* QO, const bf16* __restrict__ Kb, const bf16* __restrict__ Vb, const float* __restrict__ KS) {
    __shared__ float sc[4][1024]; __shared__ float qs[4][128];
    const int w = threadIdx.x >> 6, lane = threadIdx.x & 63;
    const int gid = blockIdx.x * 4 + w, h = gid & (NH - 1), tok = gid >> 3, b = tok / SEQ, t = tok & (SEQ - 1), blk = t >> 8;
    bf16* qrow = QO + (size_t)tok * D + h * HD;
    const float q0 = bf2f(qrow[2 * lane]), q1 = bf2f(qrow[2 * lane + 1]);
    qs[w][2 * lane] = q0; qs[w][2 * lane + 1] = q1;
    float g[8];
#pragma unroll
    for (int j = 0; j < 8; ++j) { const float* ks = KS + (size_t)(b * NBLK + j) * D + h * HD; float p = q0 * ks[2 * lane] + q1 * ks[2 * lane + 1]; p = wave_sum(p) * (1.f / MB); g[j] = (j < blk) ? p : -INFINITY; }
    unsigned sel = 0;
#pragma unroll
    for (int j = 0; j < 8; ++j) { int rank = 0;
#pragma unroll
        for (int k = 0; k < 8; ++k) if (k != j) rank += ((g[k] > g[j]) || (g[k] == g[j] && k < j)) ? 1 : 0;
        if (j < blk && rank < 3) sel |= 1u << j; }
    __syncthreads();
    unsigned packed = 0; int ns = 0;
    for (int j = 0; j <= blk; ++j) {
        const bool own = (j == blk); if (!own && !((sel >> j) & 1u)) continue;
        for (int i = 0; i < 4; ++i) { const int kk = lane + 64 * i, key = j * MB + kk;
            const bf16* kr = Kb + ((size_t)b * SEQ + key) * D + h * HD; float s = 0.f;
            for (int d = 0; d < HD; d += 8) { const uint4 u = *(const uint4*)(kr + d);
                s += qs[w][d] * __uint_as_float(u.x << 16) + qs[w][d + 1] * __uint_as_float(u.x & 0xffff0000u) + qs[w][d + 2] * __uint_as_float(u.y << 16) + qs[w][d + 3] * __uint_as_float(u.y & 0xffff0000u)
                   + qs[w][d + 4] * __uint_as_float(u.z << 16) + qs[w][d + 5] * __uint_as_float(u.z & 0xffff0000u) + qs[w][d + 6] * __uint_as_float(u.w << 16) + qs[w][d + 7] * __uint_as_float(u.w & 0xffff0000u); }
            s *= ATT_SCALE; if (own && key > t) s = -INFINITY; sc[w][ns * MB + kk] = s; }
        packed |= (unsigned)j << (4 * ns); ++ns;
    }
    const int n = ns * MB; float mx = -INFINITY;
    for (int i = lane; i < n; i += 64) mx = fmaxf(mx, sc[w][i]);
    mx = wave_max(mx); float sum = 0.f;
    for (int i = lane; i < n; i += 64) { const float p = __expf(sc[w][i] - mx); sc[w][i] = p; sum += p; }
    sum = wave_sum(sum);
    __syncthreads();
    float o0 = 0.f, o1 = 0.f;
    for (int s = 0; s < ns; ++s) { const int j = (packed >> (4 * s)) & 15; const bf16* vb = Vb + ((size_t)b * SEQ + j * MB) * D + h * HD + 2 * lane;
        for (int kk = 0; kk < MB; ++kk) { const float p = sc[w][s * MB + kk]; const unsigned u = *(const unsigned*)(vb + (size_t)kk * D); o0 += p * __uint_as_float(u << 16); o1 += p * __uint_as_float(u & 0xffff0000u); } }
    const float inv = 1.f / sum;
    qrow[2 * lane] = f2bf(o0 * inv); qrow[2 * lane + 1] = f2bf(o1 * inv);
}

extern "C" void kernel_launch(void* const* d_in, const int* in_sizes, int n_in, void* d_out, int out_size, void* d_ws, size_t ws_size, hipStream_t stream) {
    if (n_in != 18 || in_sizes[0] != T * D || out_size != T * D || ws_size < WS_END) { fprintf(stderr, "kernel_launch: unexpected shapes n_in %d in0 %d out %d ws %zu\n", n_in, n_in > 0 ? in_sizes[0] : -1, out_size, ws_size); return; }
    const float* x = (const float*)d_in[0]; const float* w1u = (const float*)d_in[1]; const float* w1d = (const float*)d_in[2];
    const float* ln1g = (const float*)d_in[3]; const float* ln1b = (const float*)d_in[4]; const float* win = (const float*)d_in[5];
    const float* bgate = (const float*)d_in[6]; const float* convw = (const float*)d_in[7]; const float* convb = (const float*)d_in[8];
    const float* wpa = (const float*)d_in[9]; const float* wpc = (const float*)d_in[10]; const float* wout = (const float*)d_in[11];
    const float* ln2g = (const float*)d_in[12]; const float* ln2b = (const float*)d_in[13]; const float* w2u = (const float*)d_in[14];
    const float* w2d = (const float*)d_in[15]; const float* ln3g = (const float*)d_in[16]; const float* ln3b = (const float*)d_in[17];
    float* out = (float*)d_out; unsigned char* ws = (unsigned char*)d_ws;
    bf16* XN = (bf16*)(ws + WS_XN); bf16* Q = (bf16*)(ws + WS_Q); bf16* Kb = (bf16*)(ws + WS_K); bf16* Vb = (bf16*)(ws + WS_V);
    bf16* P = (bf16*)(ws + WS_P); bf16* GB = (bf16*)(ws + WS_GB); bf16* H = (bf16*)(ws + WS_H); bf16* R = (bf16*)(ws + WS_R); bf16* GC = (bf16*)(ws + WS_GC); bf16* M = (bf16*)(ws + WS_M);
    float* KS = (float*)(ws + WS_KS);
    (void)hipMemsetAsync(ws + WS_CTL, 0, CTL_ZERO_BYTES, stream);
    const dim3 blk(256);
    auto mk = [](const bf16* A0, int lda0, const float* B0, int ldb0, int c0, const bf16* A1, int lda1, const float* B1, int ldb1, int c1, int K, const void* p0, const void* p1, void* p2, float sc) {
        NArgs a{}; a.A0 = A0; a.B0 = B0; a.A1 = A1; a.B1 = B1; a.p0 = p0; a.p1 = p1; a.p2 = p2; a.lda0 = lda0; a.ldb0 = ldb0; a.c0 = c0; a.lda1 = lda1; a.ldb1 = ldb1; a.c1 = c1; a.K = K; a.s = sc; return a; };
    k_cvt<<<(T * D) / 256, blk, 0, stream>>>(x, XN, (size_t)T * D);
    naive_gemm<true, E_Swiglu><<<dim3(FF / 64, T / 64), blk, 0, stream>>>(mk(XN, D, w1u, 2 * FF, 0, XN, D, w1u, 2 * FF, FF, D, nullptr, nullptr, H, 0.f));
    naive_gemm<false, E_PreLN><<<dim3(D / 64, T / 64), blk, 0, stream>>>(mk(H, FF, w1d, D, 0, H, FF, w1d, D, 0, FF, x, nullptr, out, 0.5f));
    k_ln<<<T / 4, blk, 0, stream>>>(out, ln1g, ln1b, XN);
    naive_gemm<false, E_QKV><<<dim3(3 * D / 64, T / 64), blk, 0, stream>>>(mk(XN, D, win, 8 * D, 0, XN, D, win, 8 * D, 0, D, nullptr, nullptr, Q, 0.f));
    naive_gemm<true, E_Mul><<<dim3(D / 64, T / 64), blk, 0, stream>>>(mk(XN, D, win, 8 * D, 3 * D, XN, D, win, 8 * D, 5 * D, D, nullptr, nullptr, P, 0.f));
    naive_gemm<false, E_Plain><<<dim3(D / 64, T / 64), blk, 0, stream>>>(mk(XN, D, win, 8 * D, 4 * D, XN, D, win, 8 * D, 0, D, nullptr, nullptr, GB, 0.f));
    k_ksum<<<dim3(BATCH * NBLK, D / 256), blk, 0, stream>>>(Kb, KS);
    k_attn<<<T * NH / 4, blk, 0, stream>>>(Q, Kb, Vb, KS);
    k_conv<<<(T * D) / 256, blk, 0, stream>>>(P, GB, convw, convb);
    naive_gemm<true, E_Gates><<<dim3(D / 64, T / 64), blk, 0, stream>>>(mk(XN, D, win, 8 * D, 6 * D, XN, D, win, 8 * D, 7 * D, D, bgate, GC, R, 0.f));
    naive_gemm<true, E_M><<<dim3(D / 64, T / 64), blk, 0, stream>>>(mk(Q, D, wpa, D, 0, GB, D, wpc, D, 0, D, R, GC, M, 0.f));
    naive_gemm<false, E_PreLN><<<dim3(D / 64, T / 64), blk, 0, stream>>>(mk(M, D, wout, D, 0, M, D, wout, D, 0, D, out, nullptr, out, 1.0f));
    k_ln<<<T / 4, blk, 0, stream>>>(out, ln2g, ln2b, XN);
    naive_gemm<true, E_Swiglu><<<dim3(FF / 64, T / 64), blk, 0, stream>>>(mk(XN, D, w2u, 2 * FF, 0, XN, D, w2u, 2 * FF, FF, D, nullptr, nullptr, H, 0.f));
    naive_gemm<false, E_PreLN><<<dim3(D / 64, T / 64), blk, 0, stream>>>(mk(H, FF, w2d, D, 0, H, FF, w2d, D, 0, FF, out, nullptr, out, 0.5f));
    k_ln<<<T / 4, blk, 0, stream>>>(out, ln3g, ln3b, (bf16*)nullptr);
}
```
